# Optimizing an MI355X kernel written in HIP

```python
import math
import jax, jax.numpy as jnp
from jax import lax
import numpy as np

D_MODEL = 1024
BATCH = 8
SEQ = 2048
DEPTH = 4

CHUNK = 64
N_HEADS = 8
N_KV_HEADS = 2
HEAD_DIM = 64
ATTN_WIDTH = N_HEADS * HEAD_DIM
ROPE_DIM = HEAD_DIM // 4
ROPE_THETA = 500000.0
N_IDX_HEADS = 4
IDX_DIM = 64
TOPK_MAX = 256
Q_BLOCK = 128
SGU_CHUNK = 128
SGU_GROUPS = 8
SGU_WIDTH = D_MODEL - ATTN_WIDTH
SGU_GROUP_DIM = SGU_WIDTH // SGU_GROUPS
D_FF = -(-(8 * D_MODEL) // (3 * 256)) * 256
PLE_DIM = 256
ALPHA = (2 * DEPTH) ** 0.25
BETA = (8 * DEPTH) ** -0.25
LN_EPS = 1e-5

Q_COLS = N_HEADS * HEAD_DIM
KV_COLS = N_KV_HEADS * HEAD_DIM
IQ_COLS = N_IDX_HEADS * IDX_DIM
IK_COLS = IDX_DIM
IW_COLS = N_IDX_HEADS
IN_SPLITS = (Q_COLS, KV_COLS, KV_COLS, IQ_COLS, IK_COLS, IW_COLS, SGU_WIDTH, SGU_WIDTH)
IN_COLS = Q_COLS + 2 * KV_COLS + IQ_COLS + IK_COLS + IW_COLS + 2 * SGU_WIDTH

kernel_name = "hybrid_dsa_gmlp_deepnorm_encoder"


def layer_norm(x, g, b):
    xf = x.astype(jnp.float32)
    mu = jnp.mean(xf, axis=-1, keepdims=True)
    var = jnp.mean(jnp.square(xf - mu), axis=-1, keepdims=True)
    y = (xf - mu) * lax.rsqrt(var + LN_EPS)
    return (y * g.astype(jnp.float32) + b.astype(jnp.float32)).astype(x.dtype)


def partial_rope(x, pos):
    half = ROPE_DIM // 2
    inv = ROPE_THETA ** (-2.0 * jnp.arange(half, dtype=jnp.float32) / ROPE_DIM)
    ang = pos.astype(jnp.float32)[..., None] * inv
    cos = jnp.cos(ang)[:, :, None, :]
    sin = jnp.sin(ang)[:, :, None, :]
    xr = x[..., :ROPE_DIM].astype(jnp.float32)
    x1, x2 = xr[..., :half], xr[..., half:]
    rot = jnp.concatenate([x1 * cos - x2 * sin, x2 * cos + x1 * sin], axis=-1)
    return jnp.concatenate([rot.astype(x.dtype), x[..., ROPE_DIM:]], axis=-1)


def dsa_attention(q, k, v, qi, ki, wi):
    B, S = q.shape[0], q.shape[1]
    topk = min(TOPK_MAX, S // 4)
    nb = S // Q_BLOCK
    G = N_KV_HEADS
    R = N_HEADS // N_KV_HEADS
    key_chunk = jnp.arange(S) // CHUNK

    def to_blocks(a):
        return jnp.moveaxis(a.reshape((B, nb, Q_BLOCK) + a.shape[2:]), 1, 0)

    q_b = to_blocks(q.reshape(B, S, G, R, HEAD_DIM))
    qi_b = to_blocks(qi)
    wi_b = to_blocks(wi)
    t_b = jnp.arange(S).reshape(nb, Q_BLOCK)

    def block(args):
        qb, qib, wib, tb = args
        q_chunk = tb // CHUNK
        allowed = key_chunk[None, :] <= q_chunk[:, None]
        logits = jnp.einsum('bqhd,bsd->bqhs', qib, ki)
        score = jnp.einsum('bqhs,bqh->bqs', jax.nn.relu(logits), wib).astype(jnp.float32)
        score = jnp.where(allowed[None], score, -jnp.inf)
        _, idx = lax.top_k(score, topk)
        k_sel = jax.vmap(lambda kb, ib: kb[ib])(k, idx)
        v_sel = jax.vmap(lambda vb, ib: vb[ib])(v, idx)
        valid = key_chunk[idx] <= q_chunk[None, :, None]
        s = jnp.einsum('bqgrd,bqkgd->bqgrk', qb, k_sel).astype(jnp.float32) * (HEAD_DIM ** -0.5)
        s = jnp.where(valid[:, :, None, None, :], s, -jnp.inf)
        pr = jax.nn.softmax(s, axis=-1).astype(v.dtype)
        return jnp.einsum('bqgrk,bqkgd->bqgrd', pr, v_sel)

    out = lax.map(block, (q_b, qi_b, wi_b, t_b))
    return jnp.moveaxis(out, 0, 1).reshape(B, S, ATTN_WIDTH)


def spatial_gating(u, v, w_s, b_s, g, bta):
    B, S = u.shape[0], u.shape[1]
    v = layer_norm(v, g, bta)
    nc = S // SGU_CHUNK
    vb = v.reshape(B, nc, SGU_CHUNK, SGU_GROUPS, SGU_GROUP_DIM)
    tri = jnp.tril(jnp.ones((SGU_CHUNK, SGU_CHUNK), dtype=bool))
    w = jnp.where(tri[None], w_s, jnp.zeros_like(w_s))
    mixed = jnp.einsum('gts,bcsgd->bctgd', w, vb) + jnp.swapaxes(b_s, 0, 1)[None, None, :, :, None]
    return u * mixed.reshape(B, S, SGU_WIDTH)


def setup_inputs(seed: int = 0) -> dict:
    key = jax.random.key(seed)
    ks = jax.random.split(key, 20)

    def nrm(k, shape, scale):
        return jax.random.normal(k, shape, jnp.float32) * scale

    x = nrm(ks[0], (BATCH, SEQ, D_MODEL), 1.0)
    p = nrm(ks[1], (DEPTH, BATCH, SEQ, PLE_DIM), 1.0)
    start = jax.random.randint(ks[2], (BATCH, 1), 0, 64, dtype=jnp.int32) * CHUNK
    positions = (start + jnp.arange(SEQ, dtype=jnp.int32)[None, :]).astype(jnp.int32)
    return {
        "x": x,
        "p": p,
        "positions": positions,
        "w_in": nrm(ks[3], (DEPTH, D_MODEL, IN_COLS), D_MODEL ** -0.5),
        "w_o": nrm(ks[4], (DEPTH, D_MODEL, D_MODEL), BETA * D_MODEL ** -0.5),
        "ln1_g": 1.0 + nrm(ks[5], (DEPTH, D_MODEL), 0.02),
        "ln1_b": nrm(ks[6], (DEPTH, D_MODEL), 0.02),
        "ln2_g": 1.0 + nrm(ks[7], (DEPTH, D_MODEL), 0.02),
        "ln2_b": nrm(ks[8], (DEPTH, D_MODEL), 0.02),
        "sgu_w": nrm(ks[9], (DEPTH, SGU_GROUPS, SGU_CHUNK, SGU_CHUNK), SGU_CHUNK ** -0.5),
        "sgu_b": 1.0 + nrm(ks[10], (DEPTH, SGU_GROUPS, SGU_CHUNK), 0.02),
        "sgu_ln_g": 1.0 + nrm(ks[11], (DEPTH, SGU_WIDTH), 0.02),
        "sgu_ln_b": nrm(ks[12], (DEPTH, SGU_WIDTH), 0.02),
        "w_ffn_in": nrm(ks[13], (DEPTH, D_MODEL, 2 * D_FF), D_MODEL ** -0.5),
        "w_ffn_out": nrm(ks[14], (DEPTH, D_FF, D_MODEL), BETA * D_FF ** -0.5),
        "w_ple": nrm(ks[15], (DEPTH, PLE_DIM, D_MODEL), PLE_DIM ** -0.5),
        "w_ple_gate": nrm(ks[16], (DEPTH, D_MODEL, D_MODEL), D_MODEL ** -0.5),
    }


def reference(x, p, positions, w_in, w_o, ln1_g, ln1_b, ln2_g, ln2_b, sgu_w, sgu_b,
              sgu_ln_g, sgu_ln_b, w_ffn_in, w_ffn_out, w_ple, w_ple_gate):
    B, S = x.shape[0], x.shape[1]
    split_points = [int(o) for o in np.cumsum(IN_SPLITS)[:-1]]
    for i in range(DEPTH):
        h = x @ w_in[i]
        q, k, v, qi, ki, wi, u, vs = jnp.split(h, split_points, axis=-1)
        q = partial_rope(q.reshape(B, S, N_HEADS, HEAD_DIM), positions)
        k = partial_rope(k.reshape(B, S, N_KV_HEADS, HEAD_DIM), positions)
        v = v.reshape(B, S, N_KV_HEADS, HEAD_DIM)
        qi = partial_rope(qi.reshape(B, S, N_IDX_HEADS, IDX_DIM), positions)
        ki = partial_rope(ki.reshape(B, S, 1, IDX_DIM), positions)[:, :, 0]
        wi = wi * ((N_IDX_HEADS * IDX_DIM) ** -0.5)
        a_out = dsa_attention(q, k, v, qi, ki, wi)
        b_out = spatial_gating(jax.nn.gelu(u), jax.nn.gelu(vs), sgu_w[i], sgu_b[i],
                               sgu_ln_g[i], sgu_ln_b[i])
        mix = jnp.concatenate([a_out, b_out], axis=-1) @ w_o[i]
        x = layer_norm(ALPHA * x + mix, ln1_g[i], ln1_b[i])
        gate, up = jnp.split(x @ w_ffn_in[i], 2, axis=-1)
        ffn = (jax.nn.silu(gate) * up) @ w_ffn_out[i]
        ple = (p[i] @ w_ple[i]) * jax.nn.sigmoid(x @ w_ple_gate[i])
        x = layer_norm(ALPHA * x + ffn + ple, ln2_g[i], ln2_b[i])
    return x
```

```cpp
#include <hip/hip_runtime.h>
#include <cstdio>
#include <cstdint>
#include <cmath>

namespace {
constexpr int D_MODEL = 1024, BATCH = 8, SEQ = 2048, DEPTH = 4, M = BATCH * SEQ;
constexpr int IN_COLS = 2116, D_FF = 2816, PLE_DIM = 256;
constexpr int C_Q = 0, C_K = 512, C_V = 640, C_QI = 768, C_KI = 1024, C_WI = 1088, C_U = 1092, C_VS = 1604;
constexpr float LN_EPS = 1e-5f;
constexpr float ALPHA = 1.681792830507429f;


__global__ void __launch_bounds__(256) gemm_f32(const float* __restrict__ A, int lda, const float* __restrict__ W, int ldw,
                                                float* __restrict__ C, int ldc, int Mr, int N, int K) {
    __shared__ float As[16][64 + 4];
    __shared__ float Bs[16][64 + 4];
    const int tid = threadIdx.x, tx = tid & 15, ty = tid >> 4;
    const int m0 = blockIdx.y * 64, n0 = blockIdx.x * 64;
    float acc[4][4];
#pragma unroll
    for (int i = 0; i < 4; ++i)
#pragma unroll
        for (int j = 0; j < 4; ++j) acc[i][j] = 0.f;
    for (int k0 = 0; k0 < K; k0 += 16) {
#pragma unroll
        for (int i = 0; i < 4; ++i) {
            const int e = tid + i * 256, r = e >> 4, kk = e & 15;
            As[kk][r] = A[(size_t)(m0 + r) * lda + k0 + kk];
        }
#pragma unroll
        for (int i = 0; i < 4; ++i) {
            const int e = tid + i * 256, kk = e >> 6, c = e & 63;
            Bs[kk][c] = (n0 + c < N) ? W[(size_t)(k0 + kk) * ldw + n0 + c] : 0.f;
        }
        __syncthreads();
#pragma unroll
        for (int kk = 0; kk < 16; ++kk) {
            float a[4], b[4];
#pragma unroll
            for (int i = 0; i < 4; ++i) a[i] = As[kk][ty * 4 + i];
#pragma unroll
            for (int j = 0; j < 4; ++j) b[j] = Bs[kk][tx * 4 + j];
#pragma unroll
            for (int i = 0; i < 4; ++i)
#pragma unroll
                for (int j = 0; j < 4; ++j) acc[i][j] = fmaf(a[i], b[j], acc[i][j]);
        }
        __syncthreads();
    }
#pragma unroll
    for (int i = 0; i < 4; ++i)
#pragma unroll
        for (int j = 0; j < 4; ++j) {
            const int r = m0 + ty * 4 + i, c = n0 + tx * 4 + j;
            if (c < N) C[(size_t)r * ldc + c] = acc[i][j];
        }
}

__device__ __forceinline__ float gelu_tanh(float x) {
    const float u = 0.7978845608028654f * (x + 0.044715f * x * x * x);
    return 0.5f * x * (1.f + tanhf(u));
}
__device__ __forceinline__ void sincos_acc(float ang, float& s, float& c) {
    const double a = (double)ang;
    const double t = a * 0.15915494309189535;
    const double fr = t - rint(t);
    const double r = fr * 6.283185307179586;
    const double r2 = r * r;
    double sp = -1.0 / 121645100408832000.0;
    sp = sp * r2 + 1.0 / 355687428096000.0;
    sp = sp * r2 - 1.0 / 1307674368000.0;
    sp = sp * r2 + 1.0 / 6227020800.0;
    sp = sp * r2 - 1.0 / 39916800.0;
    sp = sp * r2 + 1.0 / 362880.0;
    sp = sp * r2 - 1.0 / 5040.0;
    sp = sp * r2 + 1.0 / 120.0;
    sp = sp * r2 - 1.0 / 6.0;
    sp = sp * r2 + 1.0;
    double cp = 1.0 / 2432902008176640000.0;
    cp = cp * r2 - 1.0 / 6402373705728000.0;
    cp = cp * r2 + 1.0 / 20922789888000.0;
    cp = cp * r2 - 1.0 / 87178291200.0;
    cp = cp * r2 + 1.0 / 479001600.0;
    cp = cp * r2 - 1.0 / 3628800.0;
    cp = cp * r2 + 1.0 / 40320.0;
    cp = cp * r2 - 1.0 / 720.0;
    cp = cp * r2 + 1.0 / 24.0;
    cp = cp * r2 - 0.5;
    cp = cp * r2 + 1.0;
    s = (float)(sp * r); c = (float)cp;
}

__global__ void __launch_bounds__(256) h_post(float* __restrict__ H, const int* __restrict__ pos) {
    const size_t idx = (size_t)blockIdx.x * 256 + threadIdx.x;
    if (idx >= (size_t)M * IN_COLS) return;
    const int row = (int)(idx / IN_COLS), c = (int)(idx % IN_COLS);
    float* h = H + (size_t)row * IN_COLS;
    if (c >= C_U) { h[c] = gelu_tanh(h[c]); return; }
    if (c >= C_WI) { h[c] = h[c] * 0.0625f; return; }
    if (c >= C_V && c < C_QI) return;
    const int d = c & 63;
    if (d >= 8) return;
    const float inv = (float)exp2((double)(-d) * 2.3664460711655217);
    const float ang = (float)pos[row] * inv;
    float s, co; sincos_acc(ang, s, co);
    const float x1 = h[c], x2 = h[c + 8];
    h[c] = x1 * co - x2 * s;
    h[c + 8] = x2 * co + x1 * s;
}

__global__ void __launch_bounds__(256) idx_scores(const float* __restrict__ H, float* __restrict__ SC) {
    const int ts = blockIdx.x, tq = blockIdx.y, b = blockIdx.z;
    if (ts > tq) return;
    __shared__ float qs[64 * 65];
    __shared__ float ks[64 * 65];
    __shared__ float ws[256];
    const int tid = threadIdx.x;
    const size_t rq = (size_t)b * SEQ + tq * 64, rk = (size_t)b * SEQ + ts * 64;
    for (int e = tid; e < 64 * 64; e += 256) { const int r = e >> 6, c = e & 63; ks[r * 65 + c] = H[(rk + r) * IN_COLS + C_KI + c]; }
    { const int r = tid >> 2, c = tid & 3; ws[tid] = H[(rq + r) * IN_COLS + C_WI + c]; }
    const int tx = tid & 15, ty = tid >> 4;
    float out[4][4];
#pragma unroll
    for (int i = 0; i < 4; ++i)
#pragma unroll
        for (int j = 0; j < 4; ++j) out[i][j] = 0.f;
    for (int h = 0; h < 4; ++h) {
        __syncthreads();
        for (int e = tid; e < 64 * 64; e += 256) { const int r = e >> 6, c = e & 63; qs[r * 65 + c] = H[(rq + r) * IN_COLS + C_QI + h * 64 + c]; }
        __syncthreads();
        float a[4][4];
#pragma unroll
        for (int i = 0; i < 4; ++i)
#pragma unroll
            for (int j = 0; j < 4; ++j) a[i][j] = 0.f;
        for (int d = 0; d < 64; ++d) {
            float qv[4], kv[4];
#pragma unroll
            for (int i = 0; i < 4; ++i) qv[i] = qs[(ty * 4 + i) * 65 + d];
#pragma unroll
            for (int j = 0; j < 4; ++j) kv[j] = ks[(tx * 4 + j) * 65 + d];
#pragma unroll
            for (int i = 0; i < 4; ++i)
#pragma unroll
                for (int j = 0; j < 4; ++j) a[i][j] = fmaf(qv[i], kv[j], a[i][j]);
        }
#pragma unroll
        for (int i = 0; i < 4; ++i) {
            const float w = ws[(ty * 4 + i) * 4 + h];
#pragma unroll
            for (int j = 0; j < 4; ++j) out[i][j] = fmaf(fmaxf(a[i][j], 0.f), w, out[i][j]);
        }
    }
#pragma unroll
    for (int i = 0; i < 4; ++i)
#pragma unroll
        for (int j = 0; j < 4; ++j) SC[((size_t)b * SEQ + tq * 64 + ty * 4 + i) * SEQ + ts * 64 + tx * 4 + j] = out[i][j];
}

__global__ void __launch_bounds__(256) topk_select(const float* __restrict__ SC, unsigned long long* __restrict__ MASK) {
    const int lane = threadIdx.x & 63, wv = threadIdx.x >> 6;
    const int row = blockIdx.x * 4 + wv;
    const int t = row & (SEQ - 1);
    const int nallow = ((t >> 6) + 1) * 64;
    const float* sc = SC + (size_t)row * SEQ;
    unsigned u[32];
#pragma unroll
    for (int j = 0; j < 32; ++j) {
        const int s = j * 64 + lane;
        unsigned key = 0u;
        if (s < nallow) { float v = sc[s]; if (v == 0.f) v = 0.f; const unsigned bts = __float_as_uint(v); key = (bts & 0x80000000u) ? ~bts : (bts | 0x80000000u); }
        u[j] = key;
    }
    unsigned long long myword = 0ull;
    if (nallow <= 256) {
#pragma unroll
        for (int j = 0; j < 32; ++j) { const unsigned long long bal = __ballot(j * 64 + lane < nallow); if (lane == j) myword = bal; }
    } else {
        unsigned T = 0u;
        for (int bit = 31; bit >= 0; --bit) {
            const unsigned cand = T | (1u << bit);
            int c = 0;
#pragma unroll
            for (int j = 0; j < 32; ++j) c += __popcll(__ballot(u[j] >= cand));
            if (c >= 256) T = cand;
        }
        int cgt = 0;
#pragma unroll
        for (int j = 0; j < 32; ++j) cgt += __popcll(__ballot(u[j] > T));
        const int need = 256 - cgt;
        int running = 0;
        const unsigned long long lt = (lane == 0) ? 0ull : (~0ull >> (64 - lane));
#pragma unroll
        for (int j = 0; j < 32; ++j) {
            const unsigned long long tie = __ballot(u[j] == T);
            const int rank = running + __popcll(tie & lt);
            const bool sel = (u[j] > T) || (u[j] == T && rank < need);
            const unsigned long long bal = __ballot(sel);
            if (lane == j) myword = bal;
            running += __popcll(tie);
        }
    }
    if (lane < 32) MASK[(size_t)row * 32 + lane] = myword;
}

__global__ void __launch_bounds__(256) attn_naive(const float* __restrict__ H, const unsigned long long* __restrict__ MASK, float* __restrict__ CAT) {
    const int lane = threadIdx.x & 63, wv = threadIdx.x >> 6;
    const int gw = blockIdx.x * 4 + wv;
    const int row = gw >> 3, h = gw & 7, g = h >> 2;
    const int b = row / SEQ;
    const float* qp = H + (size_t)row * IN_COLS + C_Q + h * 64;
    const unsigned long long* mk = MASK + (size_t)row * 32;
    float p[32];
    float mx = -INFINITY;
#pragma unroll
    for (int j = 0; j < 32; ++j) {
        const unsigned long long w = mk[j];
        float lg = -INFINITY;
        if ((w >> lane) & 1ull) {
            const float* kp = H + ((size_t)b * SEQ + j * 64 + lane) * IN_COLS + C_K + g * 64;
            float a = 0.f;
            for (int d = 0; d < 64; ++d) a = fmaf(qp[d], kp[d], a);
            lg = a * 0.125f;
        }
        p[j] = lg; mx = fmaxf(mx, lg);
    }
#pragma unroll
    for (int o = 1; o < 64; o <<= 1) mx = fmaxf(mx, __shfl_xor(mx, o));
    float sum = 0.f;
#pragma unroll
    for (int j = 0; j < 32; ++j) { p[j] = (p[j] == -INFINITY) ? 0.f : expf(p[j] - mx); sum += p[j]; }
#pragma unroll
    for (int o = 1; o < 64; o <<= 1) sum += __shfl_xor(sum, o);
    float acc = 0.f;
#pragma unroll
    for (int j = 0; j < 32; ++j) {
        unsigned long long w = mk[j];
        while (w) {
            const int l = __ffsll((long long)w) - 1; w &= w - 1;
            const float pv = __shfl(p[j], l);
            acc = fmaf(pv, H[((size_t)b * SEQ + j * 64 + l) * IN_COLS + C_V + g * 64 + lane], acc);
        }
    }
    CAT[(size_t)row * D_MODEL + h * 64 + lane] = acc / sum;
}

__global__ void __launch_bounds__(256) sgu_ln(float* __restrict__ H, const float* __restrict__ g, const float* __restrict__ bt) {
    const int lane = threadIdx.x & 63, wv = threadIdx.x >> 6;
    const int row = blockIdx.x * 4 + wv;
    float* v = H + (size_t)row * IN_COLS + C_VS;
    float x[8]; float s = 0.f;
#pragma unroll
    for (int j = 0; j < 8; ++j) { x[j] = v[j * 64 + lane]; s += x[j]; }
#pragma unroll
    for (int o = 1; o < 64; o <<= 1) s += __shfl_xor(s, o);
    const float mu = s * (1.f / 512.f); float q = 0.f;
#pragma unroll
    for (int j = 0; j < 8; ++j) { x[j] -= mu; q += x[j] * x[j]; }
#pragma unroll
    for (int o = 1; o < 64; o <<= 1) q += __shfl_xor(q, o);
    const float rs = 1.0f / sqrtf(q * (1.f / 512.f) + LN_EPS);
#pragma unroll
    for (int j = 0; j < 8; ++j) v[j * 64 + lane] = x[j] * rs * g[j * 64 + lane] + bt[j * 64 + lane];
}
__global__ void __launch_bounds__(256) sgu_mix(const float* __restrict__ H, const float* __restrict__ Ws, const float* __restrict__ bs, float* __restrict__ CAT) {
    const size_t idx = (size_t)blockIdx.x * 256 + threadIdx.x;
    const int row = (int)(idx >> 9), c = (int)(idx & 511);
    const int g = c >> 6, tl = row & 127, base = row - tl;
    const float* w = Ws + ((size_t)g * 128 + tl) * 128;
    float acc = 0.f;
    for (int s = 0; s <= tl; ++s) acc = fmaf(w[s], H[(size_t)(base + s) * IN_COLS + C_VS + c], acc);
    acc += bs[g * 128 + tl];
    CAT[(size_t)row * D_MODEL + 512 + c] = H[(size_t)row * IN_COLS + C_U + c] * acc;
}

__global__ void __launch_bounds__(256) ln_res(const float* __restrict__ xin, const float* __restrict__ a, const float* __restrict__ pl, const float* __restrict__ gt,
                                              const float* __restrict__ g, const float* __restrict__ bt, float* __restrict__ xout) {
    const int lane = threadIdx.x & 63, wv = threadIdx.x >> 6;
    const size_t row = (size_t)blockIdx.x * 4 + wv;
    float x[16]; float s = 0.f;
#pragma unroll
    for (int j = 0; j < 16; ++j) {
        const size_t o = row * D_MODEL + j * 64 + lane;
        float v = ALPHA * xin[o] + a[o];
        if (pl) v += pl[o] * (1.f / (1.f + expf(-gt[o])));
        x[j] = v; s += v;
    }
#pragma unroll
    for (int o = 1; o < 64; o <<= 1) s += __shfl_xor(s, o);
    const float mu = s * (1.f / 1024.f); float q = 0.f;
#pragma unroll
    for (int j = 0; j < 16; ++j) { x[j] -= mu; q += x[j] * x[j]; }
#pragma unroll
    for (int o = 1; o < 64; o <<= 1) q += __shfl_xor(q, o);
    const float rs = 1.0f / sqrtf(q * (1.f / 1024.f) + LN_EPS);
#pragma unroll
    for (int j = 0; j < 16; ++j) xout[row * D_MODEL + j * 64 + lane] = x[j] * rs * g[j * 64 + lane] + bt[j * 64 + lane];
}
__global__ void __launch_bounds__(256) swiglu(const float* __restrict__ FF, float* __restrict__ HM, int rows) {
    const size_t idx = (size_t)blockIdx.x * 256 + threadIdx.x;
    if (idx >= (size_t)rows * D_FF) return;
    const size_t r = idx / D_FF; const int c = (int)(idx % D_FF);
    const float gte = FF[r * (2 * D_FF) + c], up = FF[r * (2 * D_FF) + D_FF + c];
    HM[idx] = gte / (1.f + expf(-gte)) * up;
}
}

extern "C" void kernel_launch(void* const* d_in, const int* in_sizes, int n_in, void* d_out, int out_size, void* d_ws, size_t ws_size, hipStream_t stream) {
    const float* x_in = (const float*)d_in[0]; const float* p = (const float*)d_in[1]; const int* pos = (const int*)d_in[2];
    const float* w_in = (const float*)d_in[3]; const float* w_o = (const float*)d_in[4];
    const float* ln1_g = (const float*)d_in[5]; const float* ln1_b = (const float*)d_in[6]; const float* ln2_g = (const float*)d_in[7]; const float* ln2_b = (const float*)d_in[8];
    const float* sgu_w = (const float*)d_in[9]; const float* sgu_b = (const float*)d_in[10]; const float* sgu_ln_g = (const float*)d_in[11]; const float* sgu_ln_b = (const float*)d_in[12];
    const float* w_ffn_in = (const float*)d_in[13]; const float* w_ffn_out = (const float*)d_in[14]; const float* w_ple = (const float*)d_in[15]; const float* w_gate = (const float*)d_in[16];
    float* out = (float*)d_out;
    char* ws = (char*)d_ws;
    const size_t SZ_X = (size_t)M * D_MODEL * 4, SZ_H = (size_t)M * IN_COLS * 4, SZ_MASK = (size_t)M * 32 * 8;
    float* X = (float*)ws;
    float* H = (float*)(ws + SZ_X);
    unsigned long long* MASK = (unsigned long long*)(ws + SZ_X + SZ_H);
    float* CAT = (float*)(ws + SZ_X + SZ_H + SZ_MASK);
    float* SC = CAT;
    float* MIX = H;
    if (ws_size < SZ_X + SZ_H + SZ_MASK + (size_t)BATCH * SEQ * SEQ * 4) { fprintf(stderr, "ws too small: %zu\n", ws_size); return; }
    constexpr int RC = 4096;
    float* FFc = H;
    float* HMc = FFc + (size_t)RC * 2 * D_FF;
    float* FOc = HMc + (size_t)RC * D_FF;
    float* PLc = FOc + (size_t)RC * D_MODEL;
    float* GTc = PLc + (size_t)RC * D_MODEL;
    for (int i = 0; i < DEPTH; ++i) {
        const float* xin = (i == 0) ? x_in : X;
        float* xo2 = (i == DEPTH - 1) ? out : X;
        gemm_f32<<<dim3((IN_COLS + 63) / 64, M / 64), 256, 0, stream>>>(xin, D_MODEL, w_in + (size_t)i * D_MODEL * IN_COLS, IN_COLS, H, IN_COLS, M, IN_COLS, D_MODEL);
        h_post<<<(unsigned)(((size_t)M * IN_COLS + 255) / 256), 256, 0, stream>>>(H, pos);
        idx_scores<<<dim3(32, 32, BATCH), 256, 0, stream>>>(H, SC);
        topk_select<<<M / 4, 256, 0, stream>>>(SC, MASK);
        attn_naive<<<M * 8 / 4, 256, 0, stream>>>(H, MASK, CAT);
        sgu_ln<<<M / 4, 256, 0, stream>>>(H, sgu_ln_g + i * 512, sgu_ln_b + i * 512);
        sgu_mix<<<M * 512 / 256, 256, 0, stream>>>(H, sgu_w + (size_t)i * 8 * 128 * 128, sgu_b + i * 8 * 128, CAT);
        gemm_f32<<<dim3(D_MODEL / 64, M / 64), 256, 0, stream>>>(CAT, D_MODEL, w_o + (size_t)i * D_MODEL * D_MODEL, D_MODEL, MIX, D_MODEL, M, D_MODEL, D_MODEL);
        ln_res<<<M / 4, 256, 0, stream>>>(xin, MIX, nullptr, nullptr, ln1_g + i * D_MODEL, ln1_b + i * D_MODEL, X);
        for (int c = 0; c < M / RC; ++c) {
            const float* xc = X + (size_t)c * RC * D_MODEL;
            gemm_f32<<<dim3(2 * D_FF / 64, RC / 64), 256, 0, stream>>>(xc, D_MODEL, w_ffn_in + (size_t)i * D_MODEL * 2 * D_FF, 2 * D_FF, FFc, 2 * D_FF, RC, 2 * D_FF, D_MODEL);
            swiglu<<<(unsigned)(((size_t)RC * D_FF + 255) / 256), 256, 0, stream>>>(FFc, HMc, RC);
            gemm_f32<<<dim3(D_MODEL / 64, RC / 64), 256, 0, stream>>>(HMc, D_FF, w_ffn_out + (size_t)i * D_FF * D_MODEL, D_MODEL, FOc, D_MODEL, RC, D_MODEL, D_FF);
            gemm_f32<<<dim3(D_MODEL / 64, RC / 64), 256, 0, stream>>>(p + ((size_t)i * M + (size_t)c * RC) * PLE_DIM, PLE_DIM, w_ple + (size_t)i * PLE_DIM * D_MODEL, D_MODEL, PLc, D_MODEL, RC, D_MODEL, PLE_DIM);
            gemm_f32<<<dim3(D_MODEL / 64, RC / 64), 256, 0, stream>>>(xc, D_MODEL, w_gate + (size_t)i * D_MODEL * D_MODEL, D_MODEL, GTc, D_MODEL, RC, D_MODEL, D_MODEL);
            ln_res<<<RC / 4, 256, 0, stream>>>(xc, FOc, PLc, GTc, ln2_g + i * D_MODEL, ln2_b + i * D_MODEL, xo2 + (size_t)c * RC * D_MODEL);
        }
    }
}
```
